# Optimizing an MI355X kernel written in HIP

```python
import math
import jax, jax.numpy as jnp
from jax import lax
import numpy as np

D_MODEL = 1024
BATCH = 2
SEQ = 8192
DEPTH = 1

D_MIX = 2 * D_MODEL
D_SSD = D_MIX // 2
D_ATTN = D_MIX - D_SSD
SSD_HEAD_DIM = 64
SSD_HEADS = D_SSD // SSD_HEAD_DIM
SSD_GROUPS = 2
SSD_STATE = 128
CONV_WIDTH = 4
CHUNK = 128
D_XBC = D_SSD + 2 * SSD_GROUPS * SSD_STATE
ATTN_QK_DIM = 64
ATTN_HEADS = D_ATTN // (2 * ATTN_QK_DIM)
ATTN_V_DIM = 2 * ATTN_QK_DIM
D_QK = ATTN_HEADS * 2 * ATTN_QK_DIM
Q_BLOCK = 128
OFF_XBC = D_SSD
OFF_DT = OFF_XBC + D_XBC
OFF_Q = OFF_DT + SSD_HEADS
OFF_K = OFF_Q + D_QK
OFF_V = OFF_K + D_QK
OFF_ZA = OFF_V + ATTN_HEADS * ATTN_V_DIM
D_PROJ = OFF_ZA + D_ATTN
ALPHA = (2.0 * DEPTH) ** 0.25
BETA = (8.0 * DEPTH) ** -0.25
EPS = 1e-5

kernel_name = "hymba_ssd_diffattn_deepnorm_adaln"


def layer_norm(x, g, b):
    xf = x.astype(jnp.float32)
    mu = jnp.mean(xf, axis=-1, keepdims=True)
    var = jnp.mean(jnp.square(xf - mu), axis=-1, keepdims=True)
    y = (xf - mu) * lax.rsqrt(var + EPS)
    return (y * g + b).astype(x.dtype)


def rms_norm(x, w):
    xf = x.astype(jnp.float32)
    y = xf * lax.rsqrt(jnp.mean(jnp.square(xf), axis=-1, keepdims=True) + EPS)
    return (y * w).astype(x.dtype)


def group_rms_norm(y, w, groups):
    shp = y.shape
    yf = y.astype(jnp.float32).reshape(*shp[:-1], groups, shp[-1] // groups)
    yf = yf * lax.rsqrt(jnp.mean(jnp.square(yf), axis=-1, keepdims=True) + EPS)
    return yf.reshape(shp) * w


def causal_depthwise_conv(u, w, b):
    ch = u.shape[-1]
    out = lax.conv_general_dilated(
        u, w[:, None, :].astype(u.dtype), window_strides=(1,),
        padding=[(CONV_WIDTH - 1, 0)],
        dimension_numbers=('NWC', 'WIO', 'NWC'),
        feature_group_count=ch)
    return out + b


def decay_matrix(a_cum):
    t = a_cum.shape[-1]
    diff = a_cum[..., :, None] - a_cum[..., None, :]
    mask = jnp.tril(jnp.ones((t, t), dtype=bool))
    return jnp.exp(jnp.where(mask, diff, -jnp.inf))


def ssd_chunked(x, dt, a, bmat, cmat):
    bsz, seq, nh, hp = x.shape
    g, n = bmat.shape[2], bmat.shape[3]
    e = nh // g
    nc = seq // CHUNK
    xc = (x * dt[..., None]).reshape(bsz, nc, CHUNK, g, e, hp)
    a_dt = (dt * a).reshape(bsz, nc, CHUNK, g, e).transpose(0, 3, 4, 1, 2)
    bc = bmat.reshape(bsz, nc, CHUNK, g, n)
    cc = cmat.reshape(bsz, nc, CHUNK, g, n)
    a_cum = jnp.cumsum(a_dt, axis=-1)
    lmat = decay_matrix(a_cum)
    y_diag = jnp.einsum('bclgn,bcsgn,bgecls,bcsgep->bclgep', cc, bc, lmat, xc)
    decay_states = jnp.exp(a_cum[..., -1:] - a_cum)
    states = jnp.einsum('bclgn,bgecl,bclgep->bcgepn', bc, decay_states, xc)
    chunk_decay = jnp.exp(a_cum[..., -1])

    def step(hstate, inp):
        s_c, d_c = inp
        return hstate * d_c[..., None, None] + s_c, hstate

    init = jnp.zeros((bsz, g, e, hp, n), jnp.float32)
    _, prev = lax.scan(step, init, (states.transpose(1, 0, 2, 3, 4, 5),
                                    chunk_decay.transpose(3, 0, 1, 2)))
    y_off = jnp.einsum('bclgn,cbgepn,bgecl->bclgep', cc, prev, jnp.exp(a_cum))
    return (y_diag + y_off).reshape(bsz, seq, nh, hp)


def diff_attention(q, k, v, lam):
    bsz, seq, nh, _, dk = q.shape
    nb = seq // Q_BLOCK
    qb = (q * (dk ** -0.5)).reshape(bsz, nb, Q_BLOCK, nh, 2, dk).transpose(1, 0, 2, 3, 4, 5)
    k_pos = jnp.arange(seq)

    def block(args):
        q_blk, i = args
        s = jnp.einsum('bqhjd,bkhjd->bhjqk', q_blk, k).astype(jnp.float32)
        q_pos = i * Q_BLOCK + jnp.arange(Q_BLOCK)
        mask = k_pos[None, :] <= q_pos[:, None]
        p = jax.nn.softmax(jnp.where(mask, s, -jnp.inf), axis=-1)
        w = p[:, :, 0] - lam * p[:, :, 1]
        return jnp.einsum('bhqk,bkhd->bqhd', w.astype(v.dtype), v)

    out = lax.map(block, (qb, jnp.arange(nb)))
    return out.transpose(1, 0, 2, 3, 4).reshape(bsz, seq, nh, -1)


def hybrid_layer(x, c, w_ada, b_ada, w_in, conv_w, conv_b, dt_bias, a_log, d_skip,
                 ssd_norm_w, lambda_q1, lambda_k1, lambda_q2, lambda_k2, attn_norm_w,
                 w_out, ln_g, ln_b, layer_idx):
    bsz, seq, _ = x.shape
    mod = c @ w_ada + b_ada
    shift, scale, gate = jnp.split(mod, 3, axis=-1)
    h = x * (1.0 + scale[:, None, :]) + shift[:, None, :]
    proj = h @ w_in
    z_ssd, xbc, dt_raw, q, k, v, z_attn = jnp.split(
        proj, [OFF_XBC, OFF_DT, OFF_Q, OFF_K, OFF_V, OFF_ZA], axis=-1)

    xbc = jax.nn.silu(causal_depthwise_conv(xbc, conv_w, conv_b))
    xs, bm, cm = jnp.split(xbc, [D_SSD, D_SSD + SSD_GROUPS * SSD_STATE], axis=-1)
    dt = jax.nn.softplus(dt_raw.astype(jnp.float32) + dt_bias.astype(jnp.float32))
    a = -jnp.exp(a_log.astype(jnp.float32))
    xs_h = xs.astype(jnp.float32).reshape(bsz, seq, SSD_HEADS, SSD_HEAD_DIM)
    y = ssd_chunked(xs_h, dt, a,
                    bm.astype(jnp.float32).reshape(bsz, seq, SSD_GROUPS, SSD_STATE),
                    cm.astype(jnp.float32).reshape(bsz, seq, SSD_GROUPS, SSD_STATE))
    y = y + d_skip.astype(jnp.float32)[:, None] * xs_h
    y = y.reshape(bsz, seq, D_SSD) * jax.nn.silu(z_ssd.astype(jnp.float32))
    y_ssd = group_rms_norm(y, ssd_norm_w.astype(jnp.float32), SSD_GROUPS).astype(x.dtype)

    lambda_init = 0.8 - 0.6 * math.exp(-0.3 * layer_idx)
    lam = (jnp.exp(jnp.sum(lambda_q1.astype(jnp.float32) * lambda_k1.astype(jnp.float32)))
           - jnp.exp(jnp.sum(lambda_q2.astype(jnp.float32) * lambda_k2.astype(jnp.float32)))
           + lambda_init)
    o = diff_attention(q.reshape(bsz, seq, ATTN_HEADS, 2, ATTN_QK_DIM),
                       k.reshape(bsz, seq, ATTN_HEADS, 2, ATTN_QK_DIM),
                       v.reshape(bsz, seq, ATTN_HEADS, ATTN_V_DIM), lam)
    o = rms_norm(o, attn_norm_w) * (1.0 - lambda_init)
    y_attn = o.reshape(bsz, seq, D_ATTN) * jax.nn.silu(z_attn)

    mixed = jnp.concatenate([y_ssd, y_attn], axis=-1) @ w_out
    return layer_norm(ALPHA * x + gate[:, None, :] * mixed, ln_g, ln_b)


def setup_inputs(seed: int = 0) -> dict:
    key = jax.random.key(seed)
    ks = jax.random.split(key, 20)
    f32 = jnp.float32
    x = jax.random.normal(ks[0], (BATCH, SEQ, D_MODEL), f32)
    c = jax.random.normal(ks[1], (BATCH, D_MODEL), f32)
    w_ada = jax.random.normal(ks[2], (DEPTH, D_MODEL, 3 * D_MODEL), f32) * (0.5 * D_MODEL ** -0.5)
    b_ada = jax.random.normal(ks[3], (DEPTH, 3 * D_MODEL), f32) * 0.01
    w_in = jax.random.normal(ks[4], (DEPTH, D_MODEL, D_PROJ), f32) * D_MODEL ** -0.5
    conv_w = jax.random.normal(ks[5], (DEPTH, CONV_WIDTH, D_XBC), f32) * CONV_WIDTH ** -0.5
    conv_b = jax.random.normal(ks[6], (DEPTH, D_XBC), f32) * 0.01
    dt0 = jnp.exp(jax.random.uniform(ks[7], (DEPTH, SSD_HEADS), f32,
                                     math.log(1e-3), math.log(1e-1)))
    dt_bias = dt0 + jnp.log(-jnp.expm1(-dt0))
    a_log = jnp.log(jax.random.uniform(ks[8], (DEPTH, SSD_HEADS), f32, 1.0, 16.0))
    d_skip = 1.0 + 0.1 * jax.random.normal(ks[9], (DEPTH, SSD_HEADS), f32)
    ssd_norm_w = 1.0 + 0.01 * jax.random.normal(ks[10], (DEPTH, D_SSD), f32)
    lambda_q1 = 0.1 * jax.random.normal(ks[11], (DEPTH, ATTN_QK_DIM), f32)
    lambda_k1 = 0.1 * jax.random.normal(ks[12], (DEPTH, ATTN_QK_DIM), f32)
    lambda_q2 = 0.1 * jax.random.normal(ks[13], (DEPTH, ATTN_QK_DIM), f32)
    lambda_k2 = 0.1 * jax.random.normal(ks[14], (DEPTH, ATTN_QK_DIM), f32)
    attn_norm_w = 1.0 + 0.01 * jax.random.normal(ks[15], (DEPTH, ATTN_V_DIM), f32)
    w_out = jax.random.normal(ks[16], (DEPTH, D_MIX, D_MODEL), f32) * (D_MIX ** -0.5 * BETA)
    ln_g = 1.0 + 0.01 * jax.random.normal(ks[17], (DEPTH, D_MODEL), f32)
    ln_b = 0.01 * jax.random.normal(ks[18], (DEPTH, D_MODEL), f32)
    return {"x": x, "c": c, "w_ada": w_ada, "b_ada": b_ada, "w_in": w_in,
            "conv_w": conv_w, "conv_b": conv_b, "dt_bias": dt_bias, "a_log": a_log,
            "d_skip": d_skip, "ssd_norm_w": ssd_norm_w, "lambda_q1": lambda_q1,
            "lambda_k1": lambda_k1, "lambda_q2": lambda_q2, "lambda_k2": lambda_k2,
            "attn_norm_w": attn_norm_w, "w_out": w_out, "ln_g": ln_g, "ln_b": ln_b}


def reference(x, c, w_ada, b_ada, w_in, conv_w, conv_b, dt_bias, a_log, d_skip,
              ssd_norm_w, lambda_q1, lambda_k1, lambda_q2, lambda_k2, attn_norm_w,
              w_out, ln_g, ln_b):
    for l in range(DEPTH):
        x = hybrid_layer(x, c, w_ada[l], b_ada[l], w_in[l], conv_w[l], conv_b[l],
                         dt_bias[l], a_log[l], d_skip[l], ssd_norm_w[l],
                         lambda_q1[l], lambda_k1[l], lambda_q2[l], lambda_k2[l],
                         attn_norm_w[l], w_out[l], ln_g[l], ln_b[l], l)
    return x
```

```cpp
#include <hip/hip_runtime.h>
#include <hip/hip_bf16.h>
#include <cstdio>
#include <cstdint>
#include <cmath>
namespace pg8 {
#define PG8_LAS __attribute__((address_space(3)))
typedef unsigned short bf16_t;
typedef short bf16x8 __attribute__((ext_vector_type(8)));
typedef float f32x4 __attribute__((ext_vector_type(4)));
typedef unsigned u32x4 __attribute__((ext_vector_type(4)));
constexpr int BM = 256, BK = 64, HALF = 128, HTB = HALF * BK * 2  , STAGE_BYTES = 8 * HTB, NXCD = 8, WGM = 8;

__host__ __device__ __forceinline__ int lds_byte(int r, int c) { const int st = (r >> 4) * 2 + (c >> 5), rr = r & 15, cc = c & 31, ob = rr * 64 + cc * 2; return st * 1024 + (ob ^ (((ob >> 9) & 1) << 5)); }
__host__ __device__ __forceinline__ void stage_rc(int b, int& R, int& C) { const int st = b / 1024, sb = b % 1024, swz = sb ^ (((sb >> 9) & 1) << 5); R = (st >> 1) * 16 + swz / 64; C = (st & 1) * 32 + (swz % 64) / 2; }
__host__ __device__ __forceinline__ int perm32(int rho) { const int n = rho >> 4, i = rho & 15; return 8 * (i >> 2) + 4 * n + (i & 3); }

struct Unit { int pm, pn; };
struct Gemm { const bf16_t* A; const bf16_t* Bt; int M, N, K, lda, ldb; };

struct StaticOrder {
    int nM, nN, nwg, G, c;
    __host__ __device__ void init(int M, int N, int G_, int c_) { nM = M / BM; nN = N / BM; nwg = nM * nN; G = G_; c = c_; }
    __host__ __device__ bool next(int i, Unit& u) const {
        const long L = (long)i * G + c; if (L >= nwg) return false;
        int wgid = (int)L; { const int q = nwg / NXCD, r = nwg % NXCD, xcd = wgid % NXCD, off = wgid / NXCD; wgid = (xcd < r ? xcd * (q + 1) : r * (q + 1) + (xcd - r) * q) + off; }
        const int nig = WGM * nN, gid = wgid / nig, fm = gid * WGM, gsz = (nM - fm) < WGM ? (nM - fm) : WGM;
        u.pm = fm + ((wgid % nig) % gsz); u.pn = (wgid % nig) / gsz; return true;
    }
    __device__ __forceinline__ void a_ready(const Unit&) const {}
    __device__ __forceinline__ void done(const Unit&) const {}
};

__device__ __forceinline__ unsigned cvt_pk_bf16(float lo, float hi) { unsigned r; asm volatile("v_cvt_pk_bf16_f32 %0, %1, %2" : "=v"(r) : "v"(lo), "v"(hi)); return r; }

template <class Epi, class Sched, bool ALIGN_EPI>
__device__ __forceinline__ void gemm_phase(PG8_LAS unsigned char* lds, const Gemm g, const Sched& S, const Epi& E) {
    const int tid = threadIdx.x, wid = __builtin_amdgcn_readfirstlane(tid >> 6), lane = tid & 63, wr = wid >> 2, wc = wid & 3, fr = lane & 15, fq = lane >> 4;
    const int K = g.K, nt = K / BK;
    unsigned voffA[2], voffB[2];
#pragma unroll
    for (int i = 0; i < 2; ++i) { int R, C; stage_rc(tid * 16 + i * 8192, R, C); const int Rb = Epi::PERM ? ((R & ~31) + perm32(R & 31)) : R;
        voffA[i] = (unsigned)(R * g.lda + C) * 2u; voffB[i] = (unsigned)(Rb * g.ldb + C) * 2u; }
    const size_t kstep = (size_t)(BK * 2);
    const size_t hstepA = (size_t)HALF * g.lda * 2, hstepB = (size_t)HALF * g.ldb * 2;
    const size_t tstepA = 2 * hstepA, tstepB = 2 * hstepB;
    const unsigned ldsw = (unsigned)wid * 1024u;
    const int aoff = lds_byte(wr * 64 + fr, fq * 8), boff = lds_byte(wc * 32 + fr, fq * 8);
#define PG8_SA(b, h) (((b) * 2 + (h)) * HTB)
#define PG8_SB(b, h) ((4 + (b) * 2 + (h)) * HTB)
#define PG8_STAGE(bufoff, gbase, voff) do { _Pragma("unroll") for (int _i = 0; _i < 2; ++_i) \
        __builtin_amdgcn_global_load_lds((const unsigned*)((const char*)(gbase) + (voff)[_i]), (PG8_LAS unsigned*)(lds + (bufoff) + ldsw + _i * 8192), 16, 0, 0); } while (0)
#define PG8_LDA(dst, b, h) do { _Pragma("unroll") for (int m = 0; m < 4; ++m) _Pragma("unroll") for (int k = 0; k < 2; ++k) dst[m][k] = *(const PG8_LAS bf16x8*)(lds + PG8_SA(b, h) + aoff + m * 2048 + k * 1024); } while (0)
#define PG8_LDB(dst, b, h) do { _Pragma("unroll") for (int n = 0; n < 2; ++n) _Pragma("unroll") for (int k = 0; k < 2; ++k) dst[n][k] = *(const PG8_LAS bf16x8*)(lds + PG8_SB(b, h) + boff + n * 2048 + k * 1024); } while (0)
#define PG8_MMA(ai, bj, At, Bt) do { __builtin_amdgcn_s_setprio(1); _Pragma("unroll") for (int m = 0; m < 4; ++m) _Pragma("unroll") for (int n = 0; n < 2; ++n) _Pragma("unroll") for (int k = 0; k < 2; ++k) \
        acc[ai][bj][m][n] = __builtin_amdgcn_mfma_f32_16x16x32_bf16(Bt[n][k], At[m][k], acc[ai][bj][m][n], 0, 0, 0); __builtin_amdgcn_s_setprio(0); } while (0)
#define PG8_WAIT_V(n) asm volatile("s_waitcnt vmcnt(" #n ")" ::: "memory")
#define PG8_WAIT_L(n) asm volatile("s_waitcnt lgkmcnt(" #n ")" ::: "memory")
#define PG8_BAR __builtin_amdgcn_s_barrier()
#define PG8_SCHED __builtin_amdgcn_sched_barrier(0)
    Unit cur, nxt; int ui = 0;
    if (!S.next(0, cur)) return;
    f32x4 acc[2][2][4][2];
#pragma unroll
    for (int a = 0; a < 2; ++a)
#pragma unroll
        for (int b = 0; b < 2; ++b)
#pragma unroll
            for (int m = 0; m < 4; ++m)
#pragma unroll
                for (int n = 0; n < 2; ++n) acc[a][b][m][n] = (f32x4){0.f, 0.f, 0.f, 0.f};
    bf16x8 At[4][2], B0[2][2], B1[2][2];
    const char* cA = (const char*)g.A + (size_t)cur.pm * tstepA; const char* cB = (const char*)g.Bt + (size_t)cur.pn * tstepB;
    S.a_ready(cur);
    PG8_STAGE(PG8_SB(0, 0), cB, voffB); PG8_STAGE(PG8_SB(0, 1), cB + hstepB, voffB); PG8_STAGE(PG8_SA(0, 0), cA, voffA); PG8_STAGE(PG8_SA(0, 1), cA + hstepA, voffA);
    if (wr == 1) PG8_BAR;
    PG8_WAIT_V(2); PG8_BAR;
    PG8_STAGE(PG8_SB(1, 0), cB + kstep, voffB); PG8_STAGE(PG8_SA(1, 0), cA + kstep, voffA); PG8_STAGE(PG8_SB(1, 1), cB + hstepB + kstep, voffB);
    PG8_WAIT_V(6); PG8_BAR;
    for (;;) {
        const bool has_next = S.next(ui + 1, nxt);
        const char* nA = has_next ? (const char*)g.A + (size_t)nxt.pm * tstepA : cA; const char* nB = has_next ? (const char*)g.Bt + (size_t)nxt.pn * tstepB : cB;
        for (int t = 0; t < nt; t += 2) {
            const bool last = (t == nt - 2);
            const char* a1 = cA + (size_t)(t + 1) * kstep;
            const char* a2 = last ? nA : cA + (size_t)(t + 2) * kstep; const char* b2 = last ? nB : cB + (size_t)(t + 2) * kstep;
            const char* a3 = a2 + kstep; const char* b3 = b2 + kstep;
            if (last && has_next) S.a_ready(nxt);
            PG8_LDB(B0, 0, 0); PG8_LDB(B1, 0, 1); PG8_SCHED; PG8_LDA(At, 0, 0); PG8_STAGE(PG8_SA(1, 1), a1 + hstepA, voffA);
            PG8_WAIT_V(8); PG8_WAIT_L(0); PG8_BAR; PG8_MMA(0, 0, At, B0); PG8_MMA(0, 1, At, B1); PG8_BAR; PG8_SCHED;
            PG8_LDA(At, 0, 1); PG8_STAGE(PG8_SB(0, 0), b2, voffB); PG8_STAGE(PG8_SB(0, 1), b2 + hstepB, voffB); PG8_STAGE(PG8_SA(0, 0), a2, voffA);
            PG8_WAIT_V(8); PG8_WAIT_L(0); PG8_BAR; PG8_MMA(1, 0, At, B0); PG8_MMA(1, 1, At, B1); PG8_BAR; PG8_SCHED;
            PG8_LDB(B0, 1, 0); PG8_LDB(B1, 1, 1); PG8_SCHED; PG8_LDA(At, 1, 0); PG8_STAGE(PG8_SA(0, 1), a2 + hstepA, voffA);
            PG8_WAIT_V(8); PG8_WAIT_L(0); PG8_BAR; PG8_MMA(0, 0, At, B0); PG8_MMA(0, 1, At, B1); PG8_BAR; PG8_SCHED;
            PG8_LDA(At, 1, 1); PG8_STAGE(PG8_SB(1, 0), b3, voffB); PG8_STAGE(PG8_SB(1, 1), b3 + hstepB, voffB); PG8_STAGE(PG8_SA(1, 0), a3, voffA);
            PG8_WAIT_V(8); PG8_WAIT_L(0); PG8_BAR; PG8_MMA(1, 0, At, B0); PG8_MMA(1, 1, At, B1); PG8_BAR; PG8_SCHED;
        }
        if constexpr (ALIGN_EPI) { if (wr == 0) PG8_BAR; }
        E(acc, cur, wr, wc, fr, fq); S.done(cur);
        if (!has_next) break;
#pragma unroll
        for (int a = 0; a < 2; ++a)
#pragma unroll
            for (int b = 0; b < 2; ++b)
#pragma unroll
                for (int m = 0; m < 4; ++m)
#pragma unroll
                    for (int n = 0; n < 2; ++n) acc[a][b][m][n] = (f32x4){0.f, 0.f, 0.f, 0.f};
        cur = nxt; cA = nA; cB = nB; ++ui;
        if constexpr (ALIGN_EPI) { if (wr == 1) PG8_BAR; }
    }
    PG8_WAIT_V(0);
    if constexpr (!ALIGN_EPI) { if (wr == 0) PG8_BAR; }
    PG8_BAR;
#undef PG8_SA
#undef PG8_SB
#undef PG8_STAGE
#undef PG8_LDA
#undef PG8_LDB
#undef PG8_MMA
#undef PG8_WAIT_V
#undef PG8_WAIT_L
#undef PG8_BAR
#undef PG8_SCHED
}
}
namespace att {
typedef unsigned short bf16_t;
typedef short bf16x8 __attribute__((ext_vector_type(8)));
typedef short s16x4 __attribute__((ext_vector_type(4)));
typedef float f32x16 __attribute__((ext_vector_type(16)));
typedef float f32x4 __attribute__((ext_vector_type(4)));
typedef unsigned u32x4 __attribute__((ext_vector_type(4)));
#define ATT_LAS __attribute__((address_space(3)))
constexpr int NW = 8, QBLK = 32, KVBLK = 64, QROWS = 128;
constexpr int SHM_V = 16384, SHM_K = 16384;
constexpr int LDS_BYTES = 2 * SHM_V + 2 * SHM_K + NW * 64 * 4;
constexpr float THR = 8.f;
#define KSWZ(row, colB) ((row) * 256 + ((colB) ^ (((row) & 7) << 4)))
#define SBAR() __builtin_amdgcn_sched_barrier(0)
__device__ __forceinline__ int v_st(int k, int c) { const int kk = (k & ~0xC) | ((k & 4) << 1) | ((k & 8) >> 1); return ((kk >> 3) * 4 + (c >> 5)) * 512 + ((kk & 7) * 32 + (c & 31)) * 2; }
__device__ __forceinline__ int v_rd_base(int lane) { return ((lane & 3) << 3) | (((lane >> 2) & 3) << 6) | (((lane >> 4) & 1) << 5) | (((lane >> 5) & 1) << 8); }
constexpr int v_rd_off(int d0, int ks, int half) { return d0 * 512 + ks * 4096 + half * 2048; }
__device__ __forceinline__ int crow(int r, int hi) { return (r & 3) + 8 * (r >> 2) + 4 * hi; }
__device__ __forceinline__ unsigned cvtpk(float lo, float hi) { unsigned r; asm volatile("v_cvt_pk_bf16_f32 %0, %1, %2" : "=v"(r) : "v"(lo), "v"(hi)); return r; }

__device__ __forceinline__ void mask_tile(f32x16& p0, f32x16& p1, int dq) {
    const float NEG = -__builtin_inff();
#pragma unroll
    for (int r = 0; r < 16; ++r) {
        const int c = (r & 3) + 8 * (r >> 2);
        if (dq - c < 0) p0[r] = NEG;
        if (dq - c - 32 < 0) p1[r] = NEG;
    }
}
__device__ __forceinline__ void partialSM(f32x16& p0, f32x16& p1, float& m_reg, float& mn, float& alpha) {
    float pmax = p0[0];
#pragma unroll
    for (int r = 1; r < 16; ++r) pmax = fmaxf(pmax, p0[r]);
#pragma unroll
    for (int r = 0; r < 16; ++r) pmax = fmaxf(pmax, p1[r]);
    { auto rr = __builtin_amdgcn_permlane32_swap(__float_as_uint(pmax), __float_as_uint(pmax), false, false);
      pmax = fmaxf(__uint_as_float(rr[0]), __uint_as_float(rr[1])); }
    if (__builtin_expect(__all((pmax - m_reg) <= THR), 1)) { mn = m_reg; alpha = 1.f; }
    else { mn = fmaxf(m_reg, pmax); alpha = __builtin_amdgcn_exp2f(m_reg - mn); m_reg = mn; }
#pragma unroll
    for (int r = 0; r < 16; ++r) p0[r] = p0[r] - mn;
#pragma unroll
    for (int r = 0; r < 16; ++r) p1[r] = p1[r] - mn;
#pragma unroll
    for (int r = 0; r < 16; ++r) p0[r] = __builtin_amdgcn_exp2f(p0[r]);
}
__device__ __forceinline__ void finishSM(f32x16& p0, f32x16& p1, float alpha, float& l_reg, bf16x8& pa0, bf16x8& pa1, bf16x8& pa2, bf16x8& pa3) {
#pragma unroll
    for (int r = 0; r < 16; ++r) p1[r] = __builtin_amdgcn_exp2f(p1[r]);
    float ps = 0;
#pragma unroll
    for (int r = 0; r < 16; ++r) ps += p0[r];
#pragma unroll
    for (int r = 0; r < 16; ++r) ps += p1[r];
    { auto rr = __builtin_amdgcn_permlane32_swap(__float_as_uint(ps), __float_as_uint(ps), false, false);
      ps = __uint_as_float(rr[0]) + __uint_as_float(rr[1]); }
    l_reg = l_reg * alpha + ps;
#define PK4(P, B_, OUT) do { unsigned a0 = cvtpk(P[B_+0], P[B_+1]), a1 = cvtpk(P[B_+2], P[B_+3]);                          \
        unsigned b0 = cvtpk(P[B_+4], P[B_+5]), b1 = cvtpk(P[B_+6], P[B_+7]);                                             \
        auto r0 = __builtin_amdgcn_permlane32_swap(a0, b0, false, false); auto r1 = __builtin_amdgcn_permlane32_swap(a1, b1, false, false); \
        u32x4 w = {r0[0], r1[0], r0[1], r1[1]}; OUT = *reinterpret_cast<bf16x8*>(&w); } while (0)
    PK4(p0, 0, pa0); PK4(p0, 8, pa1); PK4(p1, 0, pa2); PK4(p1, 8, pa3);
#undef PK4
}
template <int KB>
__device__ __forceinline__ void qkt(f32x16& p0, f32x16& p1, const ATT_LAS char* K_lds, int r32, int hi, const bf16x8* qr, int jsel) {
    p0 = f32x16{}; p1 = f32x16{};
#pragma unroll
    for (int d0 = 0; d0 < 4; ++d0) { const ATT_LAS char* a = K_lds + KB * SHM_K + KSWZ(r32, (d0 * 16 + hi * 8) * 2) + jsel * 128;
        bf16x8 b0 = *reinterpret_cast<const ATT_LAS bf16x8*>(a);
        bf16x8 b1 = *reinterpret_cast<const ATT_LAS bf16x8*>(a + 32 * 256);
        p0 = __builtin_amdgcn_mfma_f32_32x32x16_bf16(b0, qr[d0], p0, 0, 0, 0);
        p1 = __builtin_amdgcn_mfma_f32_32x32x16_bf16(b1, qr[d0], p1, 0, 0, 0); }
}
template <int VB>
__device__ __forceinline__ void pv_tile(f32x16* o, int vb0, bf16x8 pa0, bf16x8 pa1, bf16x8 pa2, bf16x8 pa3) {
#define TRRD(dst, off) asm volatile("ds_read_b64_tr_b16 %0, %1 offset:%2" : "=&v"(dst) : "v"(vb0), "i"(off) : "memory")
#define PV_D0(d0) do { s16x4 l0, l1, l2, l3, h0, h1, h2, h3; constexpr int b_ = VB * SHM_V + v_rd_off(d0, 0, 0);     \
        TRRD(l0, b_); TRRD(h0, b_ + 2048); TRRD(l1, b_ + 4096); TRRD(h1, b_ + 6144); TRRD(l2, b_ + 8192); TRRD(h2, b_ + 10240); TRRD(l3, b_ + 12288); TRRD(h3, b_ + 14336); \
        asm volatile("s_waitcnt lgkmcnt(0)" ::: "memory"); SBAR();                 \
        o[d0] = __builtin_amdgcn_mfma_f32_32x32x16_bf16(pa0, (bf16x8){l0[0], l0[1], l0[2], l0[3], h0[0], h0[1], h0[2], h0[3]}, o[d0], 0, 0, 0);   \
        o[d0] = __builtin_amdgcn_mfma_f32_32x32x16_bf16(pa1, (bf16x8){l1[0], l1[1], l1[2], l1[3], h1[0], h1[1], h1[2], h1[3]}, o[d0], 0, 0, 0);   \
        o[d0] = __builtin_amdgcn_mfma_f32_32x32x16_bf16(pa2, (bf16x8){l2[0], l2[1], l2[2], l2[3], h2[0], h2[1], h2[2], h2[3]}, o[d0], 0, 0, 0);   \
        o[d0] = __builtin_amdgcn_mfma_f32_32x32x16_bf16(pa3, (bf16x8){l3[0], l3[1], l3[2], l3[3], h3[0], h3[1], h3[2], h3[3]}, o[d0], 0, 0, 0); } while (0)
    PV_D0(0); PV_D0(1); PV_D0(2); PV_D0(3);
#undef PV_D0
#undef TRRD
}

struct Tensors { bf16_t* P; const float* anw; float lam; float out_scale; float eps; };
template <int LDPc, int CQ, int CK, int CV, int CZ, int SEQc>
__device__ __forceinline__ void attn_unit(int b, int h, int qb, const Tensors& T, ATT_LAS char* lds) {
    const int tid = threadIdx.x, wid = __builtin_amdgcn_readfirstlane(tid >> 6), lane = tid & 63, r32 = lane & 31, hi = lane >> 5;
    const int jsel = wid >> 2, wq = wid & 3;
    const int NT = 2 * (qb + 1);
    const size_t rowb = (size_t)b * SEQc; constexpr int ldp = LDPc;
    const int q0 = qb * QROWS, qlo = q0 + wq * QBLK, qm = qlo + r32 - 4 * hi;
    ATT_LAS char* V_lds = lds; ATT_LAS char* K_lds = lds + 2 * SHM_V;
    ATT_LAS float* ws = (ATT_LAS float*)(lds + 2 * SHM_V + 2 * SHM_K) + wid * 64; ATT_LAS float* li_l = ws; ATT_LAS float* al_l = ws + 32; const ATT_LAS float* alh = al_l + 4 * hi; const ATT_LAS float* lih = li_l + 4 * hi;
    const int sr = tid >> 4, sc = (tid & 15) * 8, vst0 = v_st(sr, sc), vst1 = v_st(32 + sr, sc), kws = KSWZ(sr, sc * 2);
    const __amdgpu_buffer_rsrc_t rsrc = __builtin_amdgcn_make_buffer_rsrc((void*)T.P, 0, 0x7ffffff0, 0x00020000);
    const unsigned sK = (unsigned)((rowb * ldp + CK + h * 128) * 2), sV = (unsigned)((rowb * ldp + CV + h * 128) * 2);
    const unsigned voff0 = (unsigned)(sr * ldp + sc) * 2u, voff1 = voff0 + 32u * ldp * 2u;
    const int vb0 = (int)(unsigned)(uintptr_t)V_lds + v_rd_base(lane);
    float m_reg = -1e30f, l_reg = 0; f32x16 o[4] = {};
    bf16x8 qr[4];
    { const unsigned qv = (unsigned)(r32 * ldp + hi * 8) * 2u, qs = (unsigned)(((rowb + qlo) * ldp + CQ + h * 128 + jsel * 64) * 2);
#pragma unroll
      for (int d0 = 0; d0 < 4; ++d0) qr[d0] = __builtin_bit_cast(bf16x8, __builtin_amdgcn_raw_buffer_load_b128(rsrc, qv, qs + d0 * 32, 0)); }
    bf16x8 st_v0, st_v1, st_k0, st_k1;
#define VMW() asm volatile("s_waitcnt vmcnt(0)" ::: "memory")
#define BLD(voff, soff) __builtin_bit_cast(bf16x8, __builtin_amdgcn_raw_buffer_load_b128(rsrc, (voff), (soff), 0))
#define SLOAD(k0) do { const unsigned so_ = (unsigned)(k0) * (unsigned)(ldp * 2); \
                       st_v0 = BLD(voff0, sV + so_); st_v1 = BLD(voff1, sV + so_); st_k0 = BLD(voff0, sK + so_); st_k1 = BLD(voff1, sK + so_); } while (0)
#define SWRITE(bf) do { *(ATT_LAS bf16x8*)(V_lds + (bf) * SHM_V + vst0) = st_v0; *(ATT_LAS bf16x8*)(V_lds + (bf) * SHM_V + vst1) = st_v1; \
                        *(ATT_LAS bf16x8*)(K_lds + (bf) * SHM_K + kws) = st_k0; *(ATT_LAS bf16x8*)(K_lds + (bf) * SHM_K + kws + 32 * 256) = st_k1; } while (0)
#define RESC(a) do { if (__any((a) < 1.f)) { if (hi == 0) al_l[r32] = (a); asm volatile("s_waitcnt lgkmcnt(0)" ::: "memory");              \
                     _Pragma("unroll") for (int d_ = 0; d_ < 4; ++d_) _Pragma("unroll") for (int r = 0; r < 16; ++r) o[d_][r] *= al_l[crow(r, hi)]; } } while (0)
#define MASKT(P0_, P1_, t) do { const int kb_ = (t) * KVBLK; if (kb_ + KVBLK - 1 > qlo) mask_tile(P0_, P1_, qm - kb_); } while (0)
    f32x16 pA0, pA1, pB0, pB1; float mnA, mnB, alA, alB; bf16x8 pa0, pa1, pa2, pa3;
    SLOAD(0); VMW(); SWRITE(0); SBAR(); SLOAD(KVBLK);
    __syncthreads();
    SBAR(); qkt<0>(pA0, pA1, K_lds, r32, hi, qr, jsel);
    MASKT(pA0, pA1, 0); partialSM(pA0, pA1, m_reg, mnA, alA);
    VMW(); SWRITE(1);
    __syncthreads();
#define HALF_STEP(PX0, PX1, mnX, alX, PY0, PY1, alY, t, KB, VB, SB) do {                                   \
        SBAR(); qkt<KB>(PX0, PX1, K_lds, r32, hi, qr, jsel);                                               \
        finishSM(PY0, PY1, alY, l_reg, pa0, pa1, pa2, pa3); SBAR();                                        \
        if ((t) + 1 < NT) { SLOAD(((t) + 1) * KVBLK); SBAR(); }                                            \
        pv_tile<VB>(o, vb0, pa0, pa1, pa2, pa3); MASKT(PX0, PX1, (t)); partialSM(PX0, PX1, m_reg, mnX, alX); \
        __syncthreads();                                                                                   \
        if ((t) + 1 < NT) { VMW(); SWRITE(SB); }                                                           \
        RESC(alX); __syncthreads(); } while (0)
    for (int t = 1; t + 1 < NT; t += 2) {
        HALF_STEP(pB0, pB1, mnB, alB, pA0, pA1, alA, t, 1, 0, 0);
        HALF_STEP(pA0, pA1, mnA, alA, pB0, pB1, alB, t + 1, 0, 1, 1);
    }
    SBAR(); qkt<1>(pB0, pB1, K_lds, r32, hi, qr, jsel); SBAR();
    finishSM(pA0, pA1, alA, l_reg, pa0, pa1, pa2, pa3); SBAR();
    pv_tile<0>(o, vb0, pa0, pa1, pa2, pa3);
    MASKT(pB0, pB1, NT - 1); partialSM(pB0, pB1, m_reg, mnB, alB); __syncthreads(); RESC(alB);
    finishSM(pB0, pB1, alB, l_reg, pa0, pa1, pa2, pa3); SBAR(); pv_tile<1>(o, vb0, pa0, pa1, pa2, pa3);
    if (hi == 0) li_l[r32] = l_reg; asm volatile("s_waitcnt lgkmcnt(0)" ::: "memory");
    float rli[16];
#pragma unroll
    for (int r = 0; r < 16; ++r) rli[r] = __builtin_amdgcn_rcpf(lih[(r & 3) + 8 * (r >> 2)]);
    __syncthreads();
    ATT_LAS float* X1 = (ATT_LAS float*)lds;
    if (jsel == 1) {
#pragma unroll
        for (int d0 = 0; d0 < 4; ++d0)
#pragma unroll
            for (int r = 0; r < 16; ++r) X1[((wq * 4 + d0) * 16 + r) * 64 + lane] = o[d0][r] * rli[r];
    }
    __syncthreads();
    if (jsel == 0) {
        const float lam = T.lam;
        float wv[4];
#pragma unroll
        for (int d0 = 0; d0 < 4; ++d0) wv[d0] = T.anw[d0 * 32 + r32] * T.out_scale;
#pragma unroll
        for (int r = 0; r < 16; ++r) {
            float s = 0.f;
#pragma unroll
            for (int d0 = 0; d0 < 4; ++d0) { const float v = o[d0][r] * rli[r] - lam * X1[((wq * 4 + d0) * 16 + r) * 64 + lane]; o[d0][r] = v; s += v * v; }
            s += __shfl_xor(s, 1); s += __shfl_xor(s, 2); s += __shfl_xor(s, 4); s += __shfl_xor(s, 8); s += __shfl_xor(s, 16);
            const float rstd = 1.0f / sqrtf(s * (1.0f / 128.0f) + T.eps);
            const size_t rowoff = (rowb + qlo + crow(r, hi)) * ldp + h * 128;
#pragma unroll
            for (int d0 = 0; d0 < 4; ++d0) {
                const int col = d0 * 32 + r32;
                const float z = __uint_as_float(((unsigned)T.P[rowoff + CZ + col]) << 16);
                const float g = z / (1.0f + __expf(-z));
                const float v = o[d0][r] * rstd * wv[d0] * g;
                const float vn = __shfl_xor(v, 1);
                if ((r32 & 1) == 0) *(unsigned*)(T.P + rowoff + CQ + col) = cvtpk(v, vn);
            }
        }
    }
    __syncthreads();
#undef VMW
#undef SLOAD
#undef BLD
#undef SWRITE
#undef RESC
#undef MASKT
#undef HALF_STEP
}
#undef SBAR
#undef KSWZ
}
constexpr int NWAVES = 8;
constexpr int BATCH = 2, SEQ = 8192, DM = 1024, M = BATCH * SEQ;
constexpr int D_PROJ = 6672, NPROJ = 6912  , LDP = 6656  ;
constexpr int PC_ZS = 0, PC_Q = 1024, PC_K = 2048, PC_V = 3072, PC_ZA = 4096, PC_XBC = 5120;
constexpr int NHEAD_SSD = 16, HP = 64, NSTATE = 128, CHUNK = 128, NCHUNK = SEQ / CHUNK;
constexpr float EPS = 1e-5f, ALPHA = 1.189207115002721f  , LAMBDA_INIT = 0.2f;
constexpr float QSCALE = 0.125f * 1.4426950408889634f;
constexpr float LOG2E = 1.4426950408889634f;

constexpr size_t MiB = 1u << 20;
constexpr size_t WS_CTL = 0, CTL_ZERO_BYTES = 1 * MiB;
constexpr size_t WS_MOD = 1 * MiB;
constexpr size_t WS_CDEC = 1 * MiB + 64 * 1024;
constexpr size_t WS_W2T = 2 * MiB;
constexpr size_t WS_W1T = 6 * MiB;
constexpr size_t WS_DT = 20 * MiB;
constexpr size_t WS_ACUM = 21 * MiB;
constexpr size_t WS_CCV = 22 * MiB;
constexpr size_t WS_PROJ = 32 * MiB;
constexpr size_t WS_END = WS_PROJ + (size_t)M * LDP * 2;
static_assert(WS_END <= 256 * MiB, "workspace");
constexpr size_t OUT_HB = 0, OUT_YD = 0, OUT_ST = 32 * MiB;
constexpr int CW_TMO = 0, CW_CODE = 1, CW_BAR = 4096;

constexpr int RING_OFF = 0;
constexpr int LDSCTL_OFF = 147456, MISC_OFF = LDSCTL_OFF + 320;
constexpr int LDS_BYTES = 155648;
static_assert(MISC_OFF + 128 <= LDS_BYTES && pg8::STAGE_BYTES <= LDSCTL_OFF && att::LDS_BYTES <= LDSCTL_OFF, "LDS map");

#define GAS __attribute__((address_space(1)))
#define LAS __attribute__((address_space(3)))
typedef unsigned short bf16;
typedef unsigned v4u __attribute__((ext_vector_type(4)));
typedef unsigned v2u __attribute__((ext_vector_type(2)));
typedef float f32x4 __attribute__((ext_vector_type(4)));
typedef float f32x2 __attribute__((ext_vector_type(2)));
typedef short bf16x8 __attribute__((ext_vector_type(8)));
typedef GAS unsigned gu32;
typedef GAS unsigned long long gu64;
#define RLX_AGENT __ATOMIC_RELAXED, __HIP_MEMORY_SCOPE_AGENT
#define LDS_WAIT() asm volatile("s_waitcnt lgkmcnt(0)" ::: "memory")
#define VM_WAIT() asm volatile("s_waitcnt vmcnt(0)" ::: "memory")
__device__ __forceinline__ unsigned f2bf(float f) { unsigned u = __builtin_bit_cast(unsigned, f); return (u + 0x7fffu + ((u >> 16) & 1u)) >> 16; }
__device__ __forceinline__ unsigned pk2(float lo, float hi) { return f2bf(lo) | (f2bf(hi) << 16); }
__device__ __forceinline__ float bflo(unsigned u) { return __uint_as_float(u << 16); }
__device__ __forceinline__ float bfhi(unsigned u) { return __uint_as_float(u & 0xffff0000u); }
__device__ __forceinline__ float silu_f(float v) { return v / (1.0f + __expf(-v)); }
__device__ __forceinline__ float wave_sum(float v) {
#pragma unroll
    for (int o = 1; o < 64; o <<= 1) v += __shfl_xor(v, o);
    return v;
}
#define MFMA16(a, b, c) __builtin_amdgcn_mfma_f32_16x16x32_bf16((a), (b), (c), 0, 0, 0)

#define XB_TMO      128
#define XB_XCNT(j)  (256  + 64 * (j))
#define XB_XSUB(j)  (1280 + 64 * (j))
#define XB_XGEN(j)  (2304 + 64 * (j))
#define XB_TOP      3328
#define XB_TOPGEN   3392
#define XCD_BAR_WORDS 3456
#define XB_SPIN_CAP (1u << 18)
__device__ __forceinline__ unsigned xb_ld(unsigned* p)              { return __hip_atomic_load(p, __ATOMIC_RELAXED, __HIP_MEMORY_SCOPE_AGENT); }
__device__ __forceinline__ unsigned xb_add(unsigned* p, unsigned v) { return __hip_atomic_fetch_add(p, v, __ATOMIC_RELAXED, __HIP_MEMORY_SCOPE_AGENT); }
__device__ __forceinline__ unsigned xb_xcc_id() { return (unsigned)__builtin_amdgcn_s_getreg((3 << 11) | 20) & 0xFu; }
#define XB_SPIN(cond, bar) do { unsigned _sp = 0; while (cond) { __builtin_amdgcn_s_sleep(1); \
    if ((++_sp & 255u) == 0u) { if (xb_ld(&(bar)[XB_TMO])) break; if (_sp > XB_SPIN_CAP) { atomicAdd(&(bar)[XB_TMO], 1u); break; } } } } while (0)
struct XcdBarrier { unsigned* bar; unsigned x; volatile LAS unsigned* st; };
__device__ __forceinline__ XcdBarrier xcd_barrier_post(unsigned* bar, volatile LAS unsigned* st) {
    XcdBarrier b; b.bar = bar; b.x = xb_xcc_id(); b.st = st;
    if (threadIdx.x == 0) (void)xb_add(&bar[XB_XCNT(b.x)], 1u);
    return b;
}
__device__ __forceinline__ void xcd_barrier_complete(unsigned* bar, unsigned x, unsigned& nloc, unsigned& nx) {
    const unsigned G = gridDim.x * gridDim.y * gridDim.z;
    unsigned sum, cnt, mine, sp = 0u;
    for (;;) {
        sum = 0u; cnt = 0u; mine = 0u;
#pragma unroll
        for (unsigned j = 0; j < 16; ++j) { const unsigned c = xb_ld(&bar[XB_XCNT(j)]); sum += c; cnt += (c > 0u) ? 1u : 0u; mine = (j == x) ? c : mine; }
        if (sum == G) break;
        __builtin_amdgcn_s_sleep(1);
        if ((++sp & 255u) == 0u) { if (xb_ld(&bar[XB_TMO])) break; if (sp > XB_SPIN_CAP) { atomicAdd(&bar[XB_TMO], 1u); break; } }
    }
    nloc = mine > 0u ? mine : 1u; nx = cnt > 0u ? cnt : 1u;
}
__device__ __forceinline__ void xcd_barrier(const XcdBarrier& b) {
    asm volatile("s_waitcnt vmcnt(0)" ::: "memory");
    __syncthreads();
    if (threadIdx.x == 0) {
        unsigned* bar = b.bar;
        __builtin_amdgcn_s_waitcnt(0);
        unsigned nloc = b.st[0], nx = b.st[1];
        if (nloc == 0u) { xcd_barrier_complete(bar, b.x, nloc, nx); b.st[0] = nloc; b.st[1] = nx; }
        const unsigned old = xb_add(&bar[XB_XSUB(b.x)], 1u);
        const unsigned gen = old / nloc;
        if (old + 1u == (gen + 1u) * nloc) {
            __builtin_amdgcn_fence(__ATOMIC_RELEASE, "agent");
            asm volatile("s_waitcnt vmcnt(0)" ::: "memory");
            const unsigned og = xb_add(&bar[XB_TOP], 1u);
            const unsigned tg = og / nx;
            if (og + 1u == (tg + 1u) * nx) xb_add(&bar[XB_TOPGEN], 1u);
            else XB_SPIN(xb_ld(&bar[XB_TOPGEN]) == tg, bar);
            __builtin_amdgcn_fence(__ATOMIC_ACQUIRE, "agent");
            xb_add(&bar[XB_XGEN(b.x)], 1u);
            asm volatile("s_waitcnt vmcnt(0)" ::: "memory");
        } else {
            XB_SPIN(xb_ld(&bar[XB_XGEN(b.x)]) == gen, bar);
            __builtin_amdgcn_fence(__ATOMIC_ACQUIRE, "agent");
            asm volatile("s_waitcnt vmcnt(0)" ::: "memory");
        }
    }
    __syncthreads();
}

struct Frame {
    LAS unsigned char* lds;
    volatile LAS unsigned* MISC;
    gu32* ctl;
    int tid, lane, wave;
    int vcu, G;
    const float *x, *c, *w_ada, *b_ada, *w_in, *conv_w, *conv_b, *dt_bias, *a_log, *d_skip, *ssd_norm_w, *lq1, *lk1, *lq2, *lk2, *attn_norm_w, *w_out, *ln_g, *ln_b;
    float* out;
    bf16 *W1t, *W2t, *PROJ, *HB, *YD, *ST, *CCV;
    float *MOD, *CDEC, *DT, *ACUM;
};

__device__ __forceinline__ int win_src_col(int n) {
    if (n < 1024) return n;
    if (n < 5120) return n + 1552;
    if (n < 6656) return n - 4096;
    if (n < 6672) return n - 6656 + 2560;
    return -1;
}
template <bool MAP>
__device__ __forceinline__ void p0_transpose_item(const float* W, int K, int N, int NDEST, bf16* WT, LAS float* scr, int item, int lane) {
    const int nblk = NDEST / 32, kb = item / nblk, nb = item % nblk, k0 = 64 * kb, n0 = 32 * nb;
    const int scol = MAP ? win_src_col(n0 + (lane & 31)) : (n0 + (lane & 31));
#pragma unroll 8
    for (int i = 0; i < 32; ++i) { const int kk = 2 * i + (lane >> 5); scr[kk * 33 + (lane & 31)] = scol >= 0 ? W[(size_t)(k0 + kk) * N + scol] : 0.f; }
    LDS_WAIT(); asm volatile("" ::: "memory");
    const int c = lane & 7;
#pragma unroll
    for (int j = 0; j < 4; ++j) { const int n = (lane >> 3) + 8 * j; const LAS float* s = scr + (8 * c) * 33 + n;
        v4u o; o.x = pk2(s[0 * 33], s[1 * 33]); o.y = pk2(s[2 * 33], s[3 * 33]); o.z = pk2(s[4 * 33], s[5 * 33]); o.w = pk2(s[6 * 33], s[7 * 33]);
        *(GAS v4u*)(WT + (size_t)(n0 + n) * K + k0 + 8 * c) = o; }
    LDS_WAIT(); asm volatile("" ::: "memory");
}
__device__ __forceinline__ void p0_prologue(Frame& F) {
    LAS float* scr = (LAS float*)(F.lds + RING_OFF + F.wave * 16384);
    const int gw = F.vcu * NWAVES + F.wave, NGW = F.G * NWAVES;
    constexpr int I_1 = (DM / 64) * (NPROJ / 32), I_2 = (2048 / 64) * (DM / 32);
    for (int it = gw; it < I_1 + I_2; it += NGW) {
        if (it < I_1) p0_transpose_item<true>(F.w_in, DM, D_PROJ, NPROJ, F.W1t, scr, it, F.lane);
        else p0_transpose_item<false>(F.w_out, 2048, DM, DM, F.W2t, scr, it - I_1, F.lane);
    }
    for (int item = F.vcu; item < 192; item += F.G) {
        __syncthreads();
        const int n0 = 16 * item, col = F.lane & 15, kq = F.lane >> 4;
        float a0 = 0.f, a1 = 0.f;
#pragma unroll 8
        for (int i = 0; i < 32; ++i) { const int k = 128 * F.wave + 4 * i + kq; const float wv = F.w_ada[(size_t)k * 3072 + n0 + col]; a0 += F.c[k] * wv; a1 += F.c[1024 + k] * wv; }
        a0 += __shfl_xor(a0, 16); a0 += __shfl_xor(a0, 32); a1 += __shfl_xor(a1, 16); a1 += __shfl_xor(a1, 32);
        LAS float* red = (LAS float*)(F.lds + 131072);
        if (F.lane < 16) { red[(F.wave * 2 + 0) * 16 + col] = a0; red[(F.wave * 2 + 1) * 16 + col] = a1; }
        __syncthreads();
        if (F.tid < 32) { const int b = F.tid >> 4, cc = F.tid & 15; float s = F.b_ada[n0 + cc];
#pragma unroll
            for (int w = 0; w < 8; ++w) s += red[(w * 2 + b) * 16 + cc];
            F.MOD[b * 3072 + n0 + cc] = s; }
    }
    __syncthreads();
}

__device__ __forceinline__ void p1_modulate(Frame& F) {
    const int gw = F.vcu * NWAVES + F.wave, NGW = F.G * NWAVES;
    for (int b = 0; b < BATCH; ++b) {
        f32x4 sc[4], sh[4];
#pragma unroll
        for (int j = 0; j < 4; ++j) { sh[j] = *(const GAS f32x4*)(F.MOD + b * 3072 + 4 * F.lane + 256 * j); sc[j] = *(const GAS f32x4*)(F.MOD + b * 3072 + 1024 + 4 * F.lane + 256 * j) + 1.0f; }
        for (int t = gw; t < SEQ; t += NGW) {
            const size_t m = (size_t)b * SEQ + t;
            const GAS f32x4* xr = (const GAS f32x4*)(F.x + m * DM) + F.lane;
            GAS v2u* o8 = (GAS v2u*)(F.HB + m * DM) + F.lane;
            f32x4 v[4];
#pragma unroll
            for (int j = 0; j < 4; ++j) v[j] = xr[64 * j];
#pragma unroll
            for (int j = 0; j < 4; ++j) { const f32x4 hv = v[j] * sc[j] + sh[j]; v2u w; w.x = pk2(hv.x, hv.y); w.y = pk2(hv.z, hv.w); o8[64 * j] = w; }
        }
    }
}

struct EpiProj {
    static constexpr bool PERM = true;
    bf16* O; float* DT;
    __device__ __forceinline__ void operator()(const pg8::f32x4 (&acc)[2][2][4][2], const pg8::Unit& u, int wr, int wc, int fr, int fq) const {
        const int row0 = u.pm * 256 + wr * 64 + fr;
        if (u.pn < 26) {
            const float sc = (u.pn >= 4 && u.pn < 8) ? QSCALE : 1.0f;
            const int col0 = u.pn * 256 + wc * 32 + 8 * fq;
#pragma unroll
            for (int ai = 0; ai < 2; ++ai)
#pragma unroll
                for (int m = 0; m < 4; ++m) { bf16* rowp = O + (size_t)(row0 + ai * 128 + m * 16) * LDP + col0;
#pragma unroll
                    for (int bj = 0; bj < 2; ++bj) { const pg8::f32x4 v0 = acc[ai][bj][m][0] * sc, v1 = acc[ai][bj][m][1] * sc;
                        v4u w; w.x = pg8::cvt_pk_bf16(v0[0], v0[1]); w.y = pg8::cvt_pk_bf16(v0[2], v0[3]); w.z = pg8::cvt_pk_bf16(v1[0], v1[1]); w.w = pg8::cvt_pk_bf16(v1[2], v1[3]);
                        *(v4u*)(rowp + bj * 128) = w; } }
        } else {
            if (wc == 0 && fq < 2) {
#pragma unroll
                for (int ai = 0; ai < 2; ++ai)
#pragma unroll
                    for (int m = 0; m < 4; ++m) { float* rowp = DT + (size_t)(row0 + ai * 128 + m * 16) * 16 + 8 * fq;
                        *(f32x4*)(rowp) = acc[ai][0][m][0]; *(f32x4*)(rowp + 4) = acc[ai][0][m][1]; }
            }
        }
    }
};
struct EpiOut {
    static constexpr bool PERM = false;
    const float* x; const float* MOD; float* out;
    __device__ __forceinline__ void operator()(const pg8::f32x4 (&acc)[2][2][4][2], const pg8::Unit& u, int wr, int wc, int fr, int fq) const {
        const int row0 = u.pm * 256 + wr * 64 + fr; const int b = (u.pm * 256) / SEQ;
        const int col0 = u.pn * 256 + wc * 32 + 4 * fq;
#pragma unroll
        for (int bj = 0; bj < 2; ++bj)
#pragma unroll
            for (int n = 0; n < 2; ++n) { const int col = col0 + bj * 128 + n * 16; const pg8::f32x4 gv = *(const pg8::f32x4*)(MOD + b * 3072 + 2048 + col);
#pragma unroll
                for (int ai = 0; ai < 2; ++ai)
#pragma unroll
                    for (int m = 0; m < 4; ++m) { const size_t off = (size_t)(row0 + ai * 128 + m * 16) * DM + col;
                        const pg8::f32x4 xv = *(const pg8::f32x4*)(x + off); *(pg8::f32x4*)(out + off) = xv * ALPHA + gv * acc[ai][bj][m][n]; } }
    }
};

constexpr int TS = 136;
constexpr int S_A = 0, S_CC = 34816, S_CB = 69632, S_BT = 104448, S_DT = 139264, S_AC = 143360;
static_assert(S_AC + 4096 <= LDSCTL_OFF, "SSD LDS map");
__device__ __forceinline__ float softplus_f(float v) { return fmaxf(v, 0.f) + log1pf(__expf(-fabsf(v))); }

__device__ __forceinline__ void p3_ssd_local(Frame& F) {
    const int tid = F.tid, lane = F.lane, wave = F.wave, fr = lane & 15, fq = lane >> 4;
    LAS unsigned char* L = F.lds;
    LAS float* dtab = (LAS float*)(L + S_DT); LAS float* actab = (LAS float*)(L + S_AC);
    for (int item = F.vcu; item < BATCH * NCHUNK * 2; item += F.G) {
        const int b = item >> 7, c = (item >> 1) & 63, g = item & 1;
        const size_t r0 = (size_t)b * SEQ + (size_t)c * CHUNK;
        const bf16* Xrow = F.PROJ + r0 * LDP + PC_XBC;
        {
            const int hh = 8 * g + wave;
            const float bias = F.dt_bias[hh], a = -__expf(F.a_log[hh]);
            const float d0 = softplus_f(F.DT[(r0 + 2 * lane) * 16 + hh] + bias), d1 = softplus_f(F.DT[(r0 + 2 * lane + 1) * 16 + hh] + bias);
            const float v0 = d0 * a, v1 = d1 * a;
            float s = v0 + v1;
#pragma unroll
            for (int off = 1; off < 64; off <<= 1) { const float t = __shfl_up(s, off); if (lane >= off) s += t; }
            dtab[wave * 128 + 2 * lane] = d0; dtab[wave * 128 + 2 * lane + 1] = d1;
            actab[wave * 128 + 2 * lane] = s - v1; actab[wave * 128 + 2 * lane + 1] = s;
            F.ACUM[(r0 + 2 * lane) * 16 + hh] = s - v1; F.ACUM[(r0 + 2 * lane + 1) * 16 + hh] = s;
            if (lane == 63) F.CDEC[(b * NCHUNK + c) * 16 + hh] = __expf(s);
        }
#pragma unroll
        for (int mat = 0; mat < 2; ++mat) {
            const int q = tid & 15, ch0 = (mat ? 1280 : 1024) + 128 * g + 8 * q;
            float w[4][8], bs[8];
#pragma unroll
            for (int k = 0; k < 4; ++k) { const f32x4 w0 = *(const f32x4*)(F.conv_w + k * 1536 + ch0), w1 = *(const f32x4*)(F.conv_w + k * 1536 + ch0 + 4);
                w[k][0] = w0.x; w[k][1] = w0.y; w[k][2] = w0.z; w[k][3] = w0.w; w[k][4] = w1.x; w[k][5] = w1.y; w[k][6] = w1.z; w[k][7] = w1.w; }
            { const f32x4 b0 = *(const f32x4*)(F.conv_b + ch0), b1 = *(const f32x4*)(F.conv_b + ch0 + 4); bs[0] = b0.x; bs[1] = b0.y; bs[2] = b0.z; bs[3] = b0.w; bs[4] = b1.x; bs[5] = b1.y; bs[6] = b1.z; bs[7] = b1.w; }
#pragma unroll
            for (int it = 0; it < 4; ++it) {
                const int l = it * 32 + (tid >> 4);
                float acc[8];
#pragma unroll
                for (int i = 0; i < 8; ++i) acc[i] = bs[i];
#pragma unroll
                for (int k = 0; k < 4; ++k) {
                    const int dl = l - 3 + k;
                    v4u u = (v4u){0u, 0u, 0u, 0u};
                    if (c > 0 || dl >= 0) u = *(const v4u*)(Xrow + (ptrdiff_t)dl * LDP + ch0);
                    acc[0] += w[k][0] * bflo(u.x); acc[1] += w[k][1] * bfhi(u.x); acc[2] += w[k][2] * bflo(u.y); acc[3] += w[k][3] * bfhi(u.y);
                    acc[4] += w[k][4] * bflo(u.z); acc[5] += w[k][5] * bfhi(u.z); acc[6] += w[k][6] * bflo(u.w); acc[7] += w[k][7] * bfhi(u.w);
                }
                v4u o; o.x = pk2(silu_f(acc[0]), silu_f(acc[1])); o.y = pk2(silu_f(acc[2]), silu_f(acc[3])); o.z = pk2(silu_f(acc[4]), silu_f(acc[5])); o.w = pk2(silu_f(acc[6]), silu_f(acc[7]));
                *(LAS v4u*)(L + (mat ? S_CC : S_A) + (l * TS + 8 * q) * 2) = o;
                if (mat) *(v4u*)(F.CCV + (r0 + l) * 256 + 128 * g + 8 * q) = o;
            }
        }
#pragma unroll
        for (int it = 0; it < 2; ++it) {
            const int task = it * 512 + tid, cp = task & 63, rg = task >> 6, ch = 1024 + 128 * g + 2 * cp, l0 = 8 * rg;
            float w0[4], w1[4];
#pragma unroll
            for (int k = 0; k < 4; ++k) { const f32x2 wv = *(const f32x2*)(F.conv_w + k * 1536 + ch); w0[k] = wv.x; w1[k] = wv.y; }
            const f32x2 bv = *(const f32x2*)(F.conv_b + ch);
            float u0[11], u1[11];
#pragma unroll
            for (int i = 0; i < 11; ++i) { const int dl = l0 - 3 + i; unsigned u = 0u; if (c > 0 || dl >= 0) u = *(const unsigned*)(Xrow + (ptrdiff_t)dl * LDP + ch); u0[i] = bflo(u); u1[i] = bfhi(u); }
            float r0v[8], r1v[8];
#pragma unroll
            for (int r = 0; r < 8; ++r) { float s0 = bv.x, s1 = bv.y;
#pragma unroll
                for (int k = 0; k < 4; ++k) { s0 += w0[k] * u0[r + k]; s1 += w1[k] * u1[r + k]; }
                r0v[r] = silu_f(s0); r1v[r] = silu_f(s1); }
            v4u o0, o1; o0.x = pk2(r0v[0], r0v[1]); o0.y = pk2(r0v[2], r0v[3]); o0.z = pk2(r0v[4], r0v[5]); o0.w = pk2(r0v[6], r0v[7]);
            o1.x = pk2(r1v[0], r1v[1]); o1.y = pk2(r1v[2], r1v[3]); o1.z = pk2(r1v[4], r1v[5]); o1.w = pk2(r1v[6], r1v[7]);
            *(LAS v4u*)(L + S_BT + ((2 * cp) * TS + l0) * 2) = o0; *(LAS v4u*)(L + S_BT + ((2 * cp + 1) * TS + l0) * 2) = o1;
        }
        __syncthreads();
        {
            bf16x8 cf[4];
#pragma unroll
            for (int ks = 0; ks < 4; ++ks) cf[ks] = *(const LAS bf16x8*)(L + S_CC + ((16 * wave + fr) * TS + 32 * ks + 8 * fq) * 2);
#pragma unroll
            for (int st = 0; st < 8; ++st) {
                f32x4 acc = (f32x4){0.f, 0.f, 0.f, 0.f};
#pragma unroll
                for (int ks = 0; ks < 4; ++ks) { const bf16x8 bfr = *(const LAS bf16x8*)(L + S_A + ((16 * st + fr) * TS + 32 * ks + 8 * fq) * 2); acc = MFMA16(bfr, cf[ks], acc); }
                v2u o; o.x = pk2(acc[0], acc[1]); o.y = pk2(acc[2], acc[3]);
                *(LAS v2u*)(L + S_CB + ((16 * wave + fr) * TS + 16 * st + 4 * fq) * 2) = o;
            }
        }
        __syncthreads();
        for (int hf = 0; hf < 2; ++hf) {
#pragma unroll
            for (int it = 0; it < 4; ++it) {
                const int task = it * 512 + tid, cp = task & 127, rg = task >> 7, ch = 512 * g + 256 * hf + 2 * cp, l0 = 8 * rg;
                float w0[4], w1[4];
#pragma unroll
                for (int k = 0; k < 4; ++k) { const f32x2 wv = *(const f32x2*)(F.conv_w + k * 1536 + ch); w0[k] = wv.x; w1[k] = wv.y; }
                const f32x2 bv = *(const f32x2*)(F.conv_b + ch);
                float u0[11], u1[11];
#pragma unroll
                for (int i = 0; i < 11; ++i) { const int dl = l0 - 3 + i; unsigned u = 0u; if (c > 0 || dl >= 0) u = *(const unsigned*)(Xrow + (ptrdiff_t)dl * LDP + ch); u0[i] = bflo(u); u1[i] = bfhi(u); }
                float r0v[8], r1v[8];
#pragma unroll
                for (int r = 0; r < 8; ++r) { float s0 = bv.x, s1 = bv.y;
#pragma unroll
                    for (int k = 0; k < 4; ++k) { s0 += w0[k] * u0[r + k]; s1 += w1[k] * u1[r + k]; }
                    r0v[r] = silu_f(s0); r1v[r] = silu_f(s1); }
                v4u o0, o1; o0.x = pk2(r0v[0], r0v[1]); o0.y = pk2(r0v[2], r0v[3]); o0.z = pk2(r0v[4], r0v[5]); o0.w = pk2(r0v[6], r0v[7]);
                o1.x = pk2(r1v[0], r1v[1]); o1.y = pk2(r1v[2], r1v[3]); o1.z = pk2(r1v[4], r1v[5]); o1.w = pk2(r1v[6], r1v[7]);
                *(LAS v4u*)(L + S_A + ((2 * cp) * TS + l0) * 2) = o0; *(LAS v4u*)(L + S_A + ((2 * cp + 1) * TS + l0) * 2) = o1;
            }
            __syncthreads();
            const int el = wave >> 1, e = 4 * hf + el, hh = 8 * g + e, sub = wave & 1;
            const LAS float* ac_e = actab + e * 128; const LAS float* dt_e = dtab + e * 128;
            {
                const float Dsk = F.d_skip[hh];
#pragma unroll 1
                for (int li = 0; li < 4; ++li) {
                    const int lt = sub ? (2 + li) : (li < 2 ? li : li + 4);
                    const int l = 16 * lt + fr, nks = (lt >> 1) + 1;
                    const float ac_l = ac_e[l];
                    f32x4 acc[4];
#pragma unroll
                    for (int pt = 0; pt < 4; ++pt) acc[pt] = (f32x4){0.f, 0.f, 0.f, 0.f};
#pragma unroll 1
                    for (int ks = 0; ks < nks; ++ks) {
                        const int s0 = 32 * ks + 8 * fq;
                        const v4u cb = *(const LAS v4u*)(L + S_CB + (l * TS + s0) * 2);
                        const f32x4 as0 = *(const LAS f32x4*)(ac_e + s0), as1 = *(const LAS f32x4*)(ac_e + s0 + 4);
                        const f32x4 ds0 = *(const LAS f32x4*)(dt_e + s0), ds1 = *(const LAS f32x4*)(dt_e + s0 + 4);
                        float cbv[8] = {bflo(cb.x), bfhi(cb.x), bflo(cb.y), bfhi(cb.y), bflo(cb.z), bfhi(cb.z), bflo(cb.w), bfhi(cb.w)};
                        float asv[8] = {as0.x, as0.y, as0.z, as0.w, as1.x, as1.y, as1.z, as1.w};
                        float dsv[8] = {ds0.x, ds0.y, ds0.z, ds0.w, ds1.x, ds1.y, ds1.z, ds1.w};
                        float mv[8];
#pragma unroll
                        for (int j = 0; j < 8; ++j) { const int s = s0 + j; float v = cbv[j] * __builtin_amdgcn_exp2f((ac_l - asv[j]) * LOG2E) * dsv[j]; v = (s <= l) ? v : 0.f; if (s == l) v += Dsk; mv[j] = v; }
                        v4u mb; mb.x = pk2(mv[0], mv[1]); mb.y = pk2(mv[2], mv[3]); mb.z = pk2(mv[4], mv[5]); mb.w = pk2(mv[6], mv[7]);
                        const bf16x8 bfr = __builtin_bit_cast(bf16x8, mb);
#pragma unroll
                        for (int pt = 0; pt < 4; ++pt) { const bf16x8 afr = *(const LAS bf16x8*)(L + S_A + ((64 * el + 16 * pt + fr) * TS + s0) * 2); acc[pt] = MFMA16(afr, bfr, acc[pt]); }
                    }
#pragma unroll
                    for (int pt = 0; pt < 4; ++pt) { v2u o; o.x = pk2(acc[pt][0], acc[pt][1]); o.y = pk2(acc[pt][2], acc[pt][3]);
                        *(v2u*)(F.YD + (r0 + l) * DM + hh * 64 + 16 * pt + 4 * fq) = o; }
                }
            }
            {
                f32x4 acc[4][4];
#pragma unroll
                for (int nt = 0; nt < 4; ++nt)
#pragma unroll
                    for (int pt = 0; pt < 4; ++pt) acc[nt][pt] = (f32x4){0.f, 0.f, 0.f, 0.f};
                const float ac_end = ac_e[127];
#pragma unroll 1
                for (int ks = 0; ks < 4; ++ks) {
                    const int l0 = 32 * ks + 8 * fq;
                    const f32x4 as0 = *(const LAS f32x4*)(ac_e + l0), as1 = *(const LAS f32x4*)(ac_e + l0 + 4);
                    const f32x4 ds0 = *(const LAS f32x4*)(dt_e + l0), ds1 = *(const LAS f32x4*)(dt_e + l0 + 4);
                    float asv[8] = {as0.x, as0.y, as0.z, as0.w, as1.x, as1.y, as1.z, as1.w};
                    float dsv[8] = {ds0.x, ds0.y, ds0.z, ds0.w, ds1.x, ds1.y, ds1.z, ds1.w};
                    float scl[8];
#pragma unroll
                    for (int j = 0; j < 8; ++j) scl[j] = __builtin_amdgcn_exp2f((ac_end - asv[j]) * LOG2E) * dsv[j];
                    bf16x8 xfr[4];
#pragma unroll
                    for (int pt = 0; pt < 4; ++pt) { const v4u xv = *(const LAS v4u*)(L + S_A + ((64 * el + 16 * pt + fr) * TS + l0) * 2);
                        v4u xs; xs.x = pk2(bflo(xv.x) * scl[0], bfhi(xv.x) * scl[1]); xs.y = pk2(bflo(xv.y) * scl[2], bfhi(xv.y) * scl[3]);
                        xs.z = pk2(bflo(xv.z) * scl[4], bfhi(xv.z) * scl[5]); xs.w = pk2(bflo(xv.w) * scl[6], bfhi(xv.w) * scl[7]);
                        xfr[pt] = __builtin_bit_cast(bf16x8, xs); }
#pragma unroll
                    for (int nt = 0; nt < 4; ++nt) { const bf16x8 afr = *(const LAS bf16x8*)(L + S_BT + ((16 * (4 * sub + nt) + fr) * TS + l0) * 2);
#pragma unroll
                        for (int pt = 0; pt < 4; ++pt) acc[nt][pt] = MFMA16(afr, xfr[pt], acc[nt][pt]); }
                }
                bf16* stp = F.ST + ((size_t)((b * NCHUNK + c) * 16 + hh)) * (HP * NSTATE);
#pragma unroll
                for (int nt = 0; nt < 4; ++nt)
#pragma unroll
                    for (int pt = 0; pt < 4; ++pt) { v2u o; o.x = pk2(acc[nt][pt][0], acc[nt][pt][1]); o.y = pk2(acc[nt][pt][2], acc[nt][pt][3]);
                        *(v2u*)(stp + (16 * pt + fr) * NSTATE + 16 * (4 * sub + nt) + 4 * fq) = o; }
            }
            __syncthreads();
        }
    }
}

__device__ __forceinline__ void p4_scan(Frame& F) {
    const int nthr = F.G * NWAVES * 64;
    for (int idx = F.vcu * (NWAVES * 64) + F.tid; idx < BATCH * 16 * 64 * 64; idx += nthr) {
        const int n2 = idx & 63, p = (idx >> 6) & 63, hh = (idx >> 12) & 15, b = idx >> 16;
        unsigned* base = (unsigned*)(F.ST + ((size_t)(b * NCHUNK) * 16 + hh) * (HP * NSTATE) + p * NSTATE + 2 * n2);
        const float* cd = F.CDEC + b * NCHUNK * 16 + hh;
        const size_t cstride = (size_t)16 * HP * NSTATE / 2;
        float s0 = 0.f, s1 = 0.f;
#pragma unroll 1
        for (int c0 = 0; c0 < NCHUNK; c0 += 8) {
            unsigned st[8]; float dc[8];
#pragma unroll
            for (int i = 0; i < 8; ++i) { st[i] = base[(size_t)(c0 + i) * cstride]; dc[i] = cd[(c0 + i) * 16]; }
#pragma unroll
            for (int i = 0; i < 8; ++i) { base[(size_t)(c0 + i) * cstride] = pk2(s0, s1); s0 = s0 * dc[i] + bflo(st[i]); s1 = s1 * dc[i] + bfhi(st[i]); }
        }
    }
}

__device__ __forceinline__ void p5_ssd_combine(Frame& F) {
    const int lane = F.lane, wave = F.wave, fr = lane & 15, fq = lane >> 4;
    LAS float* ssq = (LAS float*)(F.lds);
    for (int item = F.vcu; item < BATCH * NCHUNK * 2; item += F.G) {
        const int b = item >> 7, c = (item >> 1) & 63, g = item & 1, hh = 8 * g + wave;
        const size_t r0 = (size_t)b * SEQ + (size_t)c * CHUNK;
        const bf16* prev = F.ST + ((size_t)((b * NCHUNK + c) * 16 + hh)) * (HP * NSTATE);
        f32x4 nw[4];
#pragma unroll
        for (int pt = 0; pt < 4; ++pt) nw[pt] = *(const f32x4*)(F.ssd_norm_w + hh * 64 + 16 * pt + 4 * fq);
#pragma unroll 1
        for (int lh = 0; lh < 2; ++lh) {
            f32x4 acc[4][4];
#pragma unroll
            for (int pt = 0; pt < 4; ++pt)
#pragma unroll
                for (int lt = 0; lt < 4; ++lt) acc[pt][lt] = (f32x4){0.f, 0.f, 0.f, 0.f};
#pragma unroll
            for (int ks = 0; ks < 4; ++ks) {
                bf16x8 af[4], bfv[4];
#pragma unroll
                for (int pt = 0; pt < 4; ++pt) af[pt] = *(const bf16x8*)(prev + (16 * pt + fr) * NSTATE + 32 * ks + 8 * fq);
#pragma unroll
                for (int lt = 0; lt < 4; ++lt) bfv[lt] = *(const bf16x8*)(F.CCV + (r0 + 64 * lh + 16 * lt + fr) * 256 + 128 * g + 32 * ks + 8 * fq);
#pragma unroll
                for (int pt = 0; pt < 4; ++pt)
#pragma unroll
                    for (int lt = 0; lt < 4; ++lt) acc[pt][lt] = MFMA16(af[pt], bfv[lt], acc[pt][lt]);
            }
            float sq[4];
#pragma unroll
            for (int lt = 0; lt < 4; ++lt) {
                const size_t row = r0 + 64 * lh + 16 * lt + fr;
                const float ea = __expf(F.ACUM[row * 16 + hh]);
                float s = 0.f;
#pragma unroll
                for (int pt = 0; pt < 4; ++pt) {
                    const v2u yd = *(const v2u*)(F.YD + row * DM + hh * 64 + 16 * pt + 4 * fq);
                    const v2u zz = *(const v2u*)(F.PROJ + row * LDP + PC_ZS + hh * 64 + 16 * pt + 4 * fq);
                    f32x4 y; y.x = (bflo(yd.x) + ea * acc[pt][lt][0]) * silu_f(bflo(zz.x)); y.y = (bfhi(yd.x) + ea * acc[pt][lt][1]) * silu_f(bfhi(zz.x));
                    y.z = (bflo(yd.y) + ea * acc[pt][lt][2]) * silu_f(bflo(zz.y)); y.w = (bfhi(yd.y) + ea * acc[pt][lt][3]) * silu_f(bfhi(zz.y));
                    acc[pt][lt] = y; s += (y.x * y.x + y.y * y.y) + (y.z * y.z + y.w * y.w);
                }
                s += __shfl_xor(s, 16); s += __shfl_xor(s, 32);
                sq[lt] = s;
            }
            if (fq == 0) {
#pragma unroll
                for (int lt = 0; lt < 4; ++lt) ssq[(lh * 8 + wave) * 64 + 16 * lt + fr] = sq[lt];
            }
            __syncthreads();
#pragma unroll
            for (int lt = 0; lt < 4; ++lt) {
                float tot = 0.f;
#pragma unroll
                for (int w = 0; w < 8; ++w) tot += ssq[(lh * 8 + w) * 64 + 16 * lt + fr];
                const float rstd = 1.0f / sqrtf(tot * (1.0f / 512.0f) + EPS);
                const size_t row = r0 + 64 * lh + 16 * lt + fr;
#pragma unroll
                for (int pt = 0; pt < 4; ++pt) { const f32x4 y = acc[pt][lt] * rstd * nw[pt]; v2u o; o.x = pk2(y.x, y.y); o.y = pk2(y.z, y.w);
                    *(v2u*)(F.PROJ + row * LDP + PC_ZS + hh * 64 + 16 * pt + 4 * fq) = o; }
            }
        }
        __syncthreads();
    }
}

__device__ __forceinline__ void p7_layernorm(Frame& F) {
    const int gw = F.vcu * NWAVES + F.wave, NGW = F.G * NWAVES;
    f32x4 gv[4], bv[4];
#pragma unroll
    for (int j = 0; j < 4; ++j) { gv[j] = *(const f32x4*)(F.ln_g + 4 * F.lane + 256 * j); bv[j] = *(const f32x4*)(F.ln_b + 4 * F.lane + 256 * j); }
    for (int m = gw; m < M; m += NGW) {
        GAS f32x4* xr = (GAS f32x4*)(F.out + (size_t)m * DM) + F.lane;
        f32x4 v[4]; float s = 0.f;
#pragma unroll
        for (int j = 0; j < 4; ++j) { v[j] = xr[64 * j]; s += (v[j].x + v[j].y) + (v[j].z + v[j].w); }
        const float mean = wave_sum(s) * (1.f / DM); float s2 = 0.f;
#pragma unroll
        for (int j = 0; j < 4; ++j) { v[j] = v[j] - mean; s2 += (v[j].x * v[j].x + v[j].y * v[j].y) + (v[j].z * v[j].z + v[j].w * v[j].w); }
        const float rstd = 1.f / sqrtf(wave_sum(s2) * (1.f / DM) + EPS);
#pragma unroll
        for (int j = 0; j < 4; ++j) xr[64 * j] = v[j] * rstd * gv[j] + bv[j];
    }
}

constexpr int N_PHASES = 8;
struct Args { const float* in[19]; float* out; unsigned char* ws; int ph_lo, ph_hi, use_bar, pad; };
__global__ void __launch_bounds__(NWAVES * 64, 2) hymba_fwd(Args args) {
    extern __shared__ __attribute__((aligned(16))) unsigned char lds[];
    Frame F;
    F.lds = (LAS unsigned char*)lds;
    F.MISC = (volatile LAS unsigned*)(F.lds + MISC_OFF);
    F.tid = threadIdx.x; F.lane = F.tid & 63; F.wave = __builtin_amdgcn_readfirstlane(F.tid >> 6);
    F.G = gridDim.x; { const int bx = blockIdx.x; F.vcu = (F.G % 8 == 0) ? (bx % 8) * (F.G / 8) + bx / 8 : bx; }
    unsigned char* ws = args.ws;
    F.ctl = (gu32*)(ws + WS_CTL);
    F.x = args.in[0]; F.c = args.in[1]; F.w_ada = args.in[2]; F.b_ada = args.in[3]; F.w_in = args.in[4]; F.conv_w = args.in[5]; F.conv_b = args.in[6]; F.dt_bias = args.in[7];
    F.a_log = args.in[8]; F.d_skip = args.in[9]; F.ssd_norm_w = args.in[10]; F.lq1 = args.in[11]; F.lk1 = args.in[12]; F.lq2 = args.in[13]; F.lk2 = args.in[14];
    F.attn_norm_w = args.in[15]; F.w_out = args.in[16]; F.ln_g = args.in[17]; F.ln_b = args.in[18]; F.out = args.out;
    F.W1t = (bf16*)(ws + WS_W1T); F.W2t = (bf16*)(ws + WS_W2T); F.PROJ = (bf16*)(ws + WS_PROJ);
    F.HB = (bf16*)((unsigned char*)args.out + OUT_HB); F.YD = (bf16*)((unsigned char*)args.out + OUT_YD); F.ST = (bf16*)((unsigned char*)args.out + OUT_ST);
    F.CCV = (bf16*)(ws + WS_CCV); F.MOD = (float*)(ws + WS_MOD); F.CDEC = (float*)(ws + WS_CDEC); F.DT = (float*)(ws + WS_DT); F.ACUM = (float*)(ws + WS_ACUM);
    for (int u = F.tid; u < (LDS_BYTES - LDSCTL_OFF) / 4; u += NWAVES * 64) ((LAS unsigned*)(F.lds + LDSCTL_OFF))[u] = 0u;
    __syncthreads();
    XcdBarrier bar; bar.bar = (unsigned*)(F.ctl + CW_BAR); bar.x = 0; bar.st = nullptr;
    if (args.use_bar) bar = xcd_barrier_post((unsigned*)(F.ctl + CW_BAR), F.MISC + 8);
    const int lo = args.ph_lo, hi = args.ph_hi;
#define IN(k) (lo <= (k) && (k) < hi)
#define SEAM(k) do { if (IN(k) && IN((k) + 1)) xcd_barrier(bar); } while (0)

    if (IN(0)) { p0_prologue(F); } SEAM(0);
    if (IN(1)) { p1_modulate(F); } SEAM(1);
    if (IN(2)) {
        pg8::Gemm g{F.HB, F.W1t, M, NPROJ, DM, DM, DM}; pg8::StaticOrder S; S.init(M, NPROJ, F.G, (int)blockIdx.x);
        EpiProj E{F.PROJ, F.DT};
        pg8::gemm_phase<EpiProj, pg8::StaticOrder, true>(F.lds + RING_OFF, g, S, E);
    } SEAM(2);
    if (IN(3)) { p3_ssd_local(F); } SEAM(3);
    if (IN(4)) { p4_scan(F); } SEAM(4);
    if (IN(5)) {
        p5_ssd_combine(F);
        float lam;
        { const float a = wave_sum(F.lq1[F.lane] * F.lk1[F.lane]), bq = wave_sum(F.lq2[F.lane] * F.lk2[F.lane]); lam = __expf(a) - __expf(bq) + LAMBDA_INIT; }
        att::Tensors T{F.PROJ, F.attn_norm_w, lam, 1.0f - LAMBDA_INIT, EPS};
        for (int v = F.vcu; v < 256; v += F.G) {
            const int bh = v >> 4, s = v & 15;
#pragma unroll 1
            for (int i = 0; i < 4; ++i) { const int qb = (i == 0) ? s : (i == 1) ? 63 - s : (i == 2) ? 16 + s : 47 - s;
                att::attn_unit<LDP, PC_Q, PC_K, PC_V, PC_ZA, SEQ>(bh >> 3, bh & 7, qb, T, (LAS char*)(F.lds + RING_OFF)); }
        }
    } SEAM(5);
    if (IN(6)) {
        pg8::Gemm g{F.PROJ, F.W2t, M, DM, 2048, LDP, 2048}; pg8::StaticOrder S; S.init(M, DM, F.G, (int)blockIdx.x);
        EpiOut E{F.x, F.MOD, F.out};
        pg8::gemm_phase<EpiOut, pg8::StaticOrder, true>(F.lds + RING_OFF, g, S, E);
    } SEAM(6);
    if (IN(7)) { p7_layernorm(F); }
#undef IN
#undef SEAM
}

#ifndef MK_N_LAUNCHES
#define MK_N_LAUNCHES 8
#endif
extern "C" void kernel_launch(void* const* d_in, const int* in_sizes, int n_in, void* d_out, int out_size, void* d_ws, size_t ws_size, hipStream_t stream) {
    static int grid = 0;
    if (grid == 0) {
        if (n_in != 19 || in_sizes[0] != M * DM || out_size != M * DM || ws_size < WS_END) { fprintf(stderr, "kernel_launch: unexpected shapes (n_in %d, in0 %d, out %d, ws %zu)\n", n_in, n_in > 0 ? in_sizes[0] : -1, out_size, ws_size); grid = -1; return; }
        int dev = 0, cus = 0;
        if (hipGetDevice(&dev) != hipSuccess || hipDeviceGetAttribute(&cus, hipDeviceAttributeMultiprocessorCount, dev) != hipSuccess) { grid = -1; return; }
        if (hipFuncSetAttribute((const void*)hymba_fwd, hipFuncAttributeMaxDynamicSharedMemorySize, LDS_BYTES) != hipSuccess) { fprintf(stderr, "kernel_launch: hipFuncSetAttribute failed\n"); grid = -1; return; }
        (void)hipGetLastError();
        grid = cus;
    }
    if (grid < 0) return;
    if (hipMemsetAsync((char*)d_ws + WS_CTL, 0, CTL_ZERO_BYTES, stream) != hipSuccess) return;
    Args a{};
    for (int i = 0; i < 19; ++i) a.in[i] = (const float*)d_in[i];
    a.out = (float*)d_out; a.ws = (unsigned char*)d_ws;
    if (MK_N_LAUNCHES == 1) { a.ph_lo = 0; a.ph_hi = N_PHASES; a.use_bar = 1; hipLaunchKernelGGL(hymba_fwd, dim3(grid), dim3(NWAVES * 64), LDS_BYTES, stream, a); }
    else { for (int p = 0; p < N_PHASES; ++p) { a.ph_lo = p; a.ph_hi = p + 1; a.use_bar = 0; hipLaunchKernelGGL(hymba_fwd, dim3(grid), dim3(NWAVES * 64), LDS_BYTES, stream, a); } }
}
```
